# Optimizing an MI355X kernel written in HIP

```python
import jax, jax.numpy as jnp
from jax import lax
import numpy as np

D_MODEL = 1024
BATCH = 8
SEQ = 4096
DEPTH = 2

HEAD_DIM = 64
N_MIX_HEADS = 12
N_MEM_HEADS = 4
MEM_LEN = 256
DILATED_GROUPS = ((128, 1), (512, 4), (2048, 16))
HEADS_PER_GROUP = N_MIX_HEADS // len(DILATED_GROUPS)
ROT_DIM = HEAD_DIM // 4
ROT_HALF = ROT_DIM // 2
ROPE_THETA = 500000.0
D_FF = 2816
BLOCK = 128
N_MIXERS = 2
N_A_LAYERS = (DEPTH + 1) // 2
N_B_LAYERS = DEPTH // 2
DEEPNORM_ALPHA = (2 * DEPTH) ** 0.25
DEEPNORM_BETA = (8 * DEPTH) ** -0.25
LN_EPS = 1e-5
MIX_W = N_MIX_HEADS * HEAD_DIM
MEM_W = N_MEM_HEADS * HEAD_DIM
A_IN_W = 3 * MIX_W + MEM_W
B_IN_W = 3 * MIX_W + N_MIX_HEADS + MEM_W
A_OUT_IN = HEADS_PER_GROUP * HEAD_DIM + MEM_W
B_OUT_IN = MIX_W + MEM_W
ATTN_SCALE = HEAD_DIM ** -0.5

kernel_name = "hybrid_dilated_fox_macaron_deepnorm"


def layer_norm(x, g, b):
    xf = x.astype(jnp.float32)
    mu = jnp.mean(xf, axis=-1, keepdims=True)
    var = jnp.mean(jnp.square(xf - mu), axis=-1, keepdims=True)
    y = (xf - mu) * lax.rsqrt(var + LN_EPS) * g.astype(jnp.float32) + b.astype(jnp.float32)
    return y.astype(x.dtype)


def swiglu(x, w_gate_up, w_down):
    gate, up = jnp.split(x @ w_gate_up, 2, axis=-1)
    return (jax.nn.silu(gate) * up) @ w_down


def rope_partial(t, cos, sin):
    c = cos[None, :, None, :].astype(t.dtype)
    s = sin[None, :, None, :].astype(t.dtype)
    t1 = t[..., :ROT_HALF]
    t2 = t[..., ROT_HALF:ROT_DIM]
    return jnp.concatenate([t1 * c - t2 * s, t2 * c + t1 * s, t[..., ROT_DIM:]], axis=-1)


def banded_causal_attention(q, k, v, n_back):
    N, L, H, dh = q.shape
    nb = -(-L // BLOCK)
    pad = nb * BLOCK - L
    padw = ((0, 0), (0, pad), (0, 0), (0, 0))
    q = jnp.pad(q, padw)
    k = jnp.pad(k, padw)
    v = jnp.pad(v, padw)
    qb = q.reshape(N, nb, BLOCK, H, dh)

    def with_prev(t):
        tb = t.reshape(N, nb, BLOCK, H, dh)
        prev = jnp.concatenate([jnp.zeros_like(tb[:, :1]), tb[:, :-1]], axis=1)
        return jnp.concatenate([prev, tb], axis=2)

    kk = with_prev(k)
    vv = with_prev(v)
    s = jnp.einsum('nbqhd,nbkhd->nbhqk', qb, kk).astype(jnp.float32) * ATTN_SCALE
    qi = jnp.arange(BLOCK)[:, None]
    ki = jnp.arange(2 * BLOCK)[None, :]
    dist = qi + BLOCK - ki
    kpos = jnp.arange(nb)[:, None, None] * BLOCK - BLOCK + ki[None]
    mask = (dist >= 0) & (dist <= n_back) & (kpos >= 0)
    s = jnp.where(mask[None, :, None], s, -jnp.inf)
    lse = jax.nn.logsumexp(s, axis=-1)
    p = jnp.exp(s - lse[..., None])
    o = jnp.einsum('nbhqk,nbkhd->nbqhd', p.astype(v.dtype), vv)
    o = o.reshape(N, nb * BLOCK, H, dh)[:, :L]
    lse = lse.transpose(0, 1, 3, 2).reshape(N, nb * BLOCK, H)[:, :L]
    return o, lse


def dilated_group_attention(q, k, v, window, dilation):
    B, S, H, dh = q.shape
    r = dilation
    L = S // r

    def split(t):
        return t.reshape(B, L, r, H, dh).transpose(0, 2, 1, 3, 4).reshape(B * r, L, H, dh)

    o, lse = banded_causal_attention(split(q), split(k), split(v), window // r)
    o = o.reshape(B, r, L, H, dh).transpose(0, 2, 1, 3, 4).reshape(B, S, H, dh)
    lse = lse.reshape(B, r, L, H).transpose(0, 2, 1, 3).reshape(B, S, H)
    return o, lse


def memory_attention(q_mem, mem, w_kv):
    B, S, _ = q_mem.shape
    M = mem.shape[1]
    qm = q_mem.reshape(B, S, N_MEM_HEADS, HEAD_DIM)
    km, vm = jnp.split(mem @ w_kv, 2, axis=-1)
    km = km.reshape(B, M, N_MEM_HEADS, HEAD_DIM)
    vm = vm.reshape(B, M, N_MEM_HEADS, HEAD_DIM)
    s = jnp.einsum('bshd,bmhd->bhsm', qm, km).astype(jnp.float32) * ATTN_SCALE
    p = jax.nn.softmax(s, axis=-1)
    return jnp.einsum('bhsm,bmhd->bshd', p.astype(vm.dtype), vm)


def dilated_mixer(x, mem, w_in, w_mem_kv, w_out, cos, sin):
    B, S, _ = x.shape
    h = x @ w_in
    q = h[..., :MIX_W].reshape(B, S, N_MIX_HEADS, HEAD_DIM)
    k = h[..., MIX_W:2 * MIX_W].reshape(B, S, N_MIX_HEADS, HEAD_DIM)
    v = h[..., 2 * MIX_W:3 * MIX_W].reshape(B, S, N_MIX_HEADS, HEAD_DIM)
    q_mem = h[..., 3 * MIX_W:]
    q = rope_partial(q, cos, sin)
    k = rope_partial(k, cos, sin)
    outs, lses = [], []
    for g, (window, dilation) in enumerate(DILATED_GROUPS):
        sl = slice(g * HEADS_PER_GROUP, (g + 1) * HEADS_PER_GROUP)
        o, l = dilated_group_attention(q[:, :, sl], k[:, :, sl], v[:, :, sl], window, dilation)
        outs.append(o)
        lses.append(l)
    alpha = jax.nn.softmax(jnp.stack(lses, axis=0), axis=0)
    o_a = jnp.einsum('gbsh,gbshd->bshd', alpha.astype(x.dtype), jnp.stack(outs, axis=0))
    o_m = memory_attention(q_mem, mem, w_mem_kv)
    cat = jnp.concatenate([o_a.reshape(B, S, -1), o_m.reshape(B, S, -1)], axis=-1)
    return cat @ w_out


def fox_attention(q, k, v, logf):
    B, S, H, dh = q.shape
    nq = S // BLOCK
    c = jnp.cumsum(logf, axis=1).transpose(0, 2, 1)
    qb = q.reshape(B, nq, BLOCK, H, dh).transpose(1, 0, 2, 3, 4)
    cqb = c.reshape(B, H, nq, BLOCK).transpose(2, 0, 1, 3)
    kpos = jnp.arange(S)

    def block(args):
        i, q_i, cq_i = args
        s = jnp.einsum('bqhd,bkhd->bhqk', q_i, k).astype(jnp.float32) * ATTN_SCALE
        s = s + cq_i[..., None] - c[:, :, None, :]
        qpos = i * BLOCK + jnp.arange(BLOCK)
        s = jnp.where(kpos[None, :] <= qpos[:, None], s, -jnp.inf)
        p = jax.nn.softmax(s, axis=-1)
        return jnp.einsum('bhqk,bkhd->bqhd', p.astype(v.dtype), v)

    o = lax.map(block, (jnp.arange(nq), qb, cqb))
    return o.transpose(1, 0, 2, 3, 4).reshape(B, S, H, dh)


def forgetting_mixer(x, mem, w_in, forget_bias, w_mem_kv, w_out):
    B, S, _ = x.shape
    h = x @ w_in
    q = h[..., :MIX_W].reshape(B, S, N_MIX_HEADS, HEAD_DIM)
    k = h[..., MIX_W:2 * MIX_W].reshape(B, S, N_MIX_HEADS, HEAD_DIM)
    v = h[..., 2 * MIX_W:3 * MIX_W].reshape(B, S, N_MIX_HEADS, HEAD_DIM)
    f_logit = h[..., 3 * MIX_W:3 * MIX_W + N_MIX_HEADS].astype(jnp.float32)
    q_mem = h[..., 3 * MIX_W + N_MIX_HEADS:]
    logf = jax.nn.log_sigmoid(f_logit + forget_bias.astype(jnp.float32))
    o_b = fox_attention(q, k, v, logf)
    o_m = memory_attention(q_mem, mem, w_mem_kv)
    cat = jnp.concatenate([o_b.reshape(B, S, -1), o_m.reshape(B, S, -1)], axis=-1)
    return cat @ w_out


def setup_inputs(seed: int = 0) -> dict:
    key = jax.random.key(seed)
    ks = jax.random.split(key, 16)

    def nrm(k, shape, fan_in):
        return jax.random.normal(k, shape, jnp.float32) * fan_in ** -0.5

    x = jax.random.normal(ks[0], (BATCH, SEQ, D_MODEL), jnp.float32)
    mem = jax.random.normal(ks[1], (BATCH, MEM_LEN, D_MODEL), jnp.float32)
    ffn1_w_gate_up = nrm(ks[2], (DEPTH, D_MODEL, 2 * D_FF), D_MODEL)
    ffn1_w_down = nrm(ks[3], (DEPTH, D_FF, D_MODEL), D_FF) * DEEPNORM_BETA
    ffn2_w_gate_up = nrm(ks[4], (DEPTH, D_MODEL, 2 * D_FF), D_MODEL)
    ffn2_w_down = nrm(ks[5], (DEPTH, D_FF, D_MODEL), D_FF) * DEEPNORM_BETA
    ln_gain = 1.0 + 0.02 * jax.random.normal(ks[6], (DEPTH, 3, D_MODEL), jnp.float32)
    ln_bias = 0.02 * jax.random.normal(ks[7], (DEPTH, 3, D_MODEL), jnp.float32)
    mem_w_kv = nrm(ks[8], (DEPTH, D_MODEL, 2 * MEM_W), D_MODEL)
    a_w_in = nrm(ks[9], (N_A_LAYERS, D_MODEL, A_IN_W), D_MODEL)
    a_w_out = nrm(ks[10], (N_A_LAYERS, A_OUT_IN, D_MODEL), A_OUT_IN) * DEEPNORM_BETA
    b_w_in = nrm(ks[11], (N_B_LAYERS, D_MODEL, B_IN_W), D_MODEL)
    b_forget_bias = jax.random.uniform(ks[12], (N_B_LAYERS, N_MIX_HEADS), jnp.float32, 1.0, 4.0)
    b_w_out = nrm(ks[13], (N_B_LAYERS, B_OUT_IN, D_MODEL), B_OUT_IN) * DEEPNORM_BETA
    return {"x": x, "mem": mem,
            "ffn1_w_gate_up": ffn1_w_gate_up, "ffn1_w_down": ffn1_w_down,
            "ffn2_w_gate_up": ffn2_w_gate_up, "ffn2_w_down": ffn2_w_down,
            "ln_gain": ln_gain, "ln_bias": ln_bias, "mem_w_kv": mem_w_kv,
            "a_w_in": a_w_in, "a_w_out": a_w_out,
            "b_w_in": b_w_in, "b_forget_bias": b_forget_bias, "b_w_out": b_w_out}


def reference(x, mem, ffn1_w_gate_up, ffn1_w_down, ffn2_w_gate_up, ffn2_w_down,
              ln_gain, ln_bias, mem_w_kv, a_w_in, a_w_out, b_w_in, b_forget_bias, b_w_out):
    pos = jnp.arange(x.shape[1], dtype=jnp.float32)
    inv_freq = 1.0 / (ROPE_THETA ** (jnp.arange(ROT_HALF, dtype=jnp.float32) / ROT_HALF))
    ang = pos[:, None] * inv_freq[None, :]
    cos = jnp.cos(ang)
    sin = jnp.sin(ang)
    for i in range(DEPTH):
        j = i // N_MIXERS
        x = layer_norm(DEEPNORM_ALPHA * x + 0.5 * swiglu(x, ffn1_w_gate_up[i], ffn1_w_down[i]),
                       ln_gain[i, 0], ln_bias[i, 0])
        if i % N_MIXERS == 0:
            mix = dilated_mixer(x, mem, a_w_in[j], mem_w_kv[i], a_w_out[j], cos, sin)
        else:
            mix = forgetting_mixer(x, mem, b_w_in[j], b_forget_bias[j], mem_w_kv[i], b_w_out[j])
        x = layer_norm(DEEPNORM_ALPHA * x + mix, ln_gain[i, 1], ln_bias[i, 1])
        x = layer_norm(DEEPNORM_ALPHA * x + 0.5 * swiglu(x, ffn2_w_gate_up[i], ffn2_w_down[i]),
                       ln_gain[i, 2], ln_bias[i, 2])
    return x
```

```cpp
#include <hip/hip_runtime.h>
#include <hip/hip_cooperative_groups.h>
#include <hip/hip_bf16.h>
#include <cstdio>
#include <cstdint>
#include <cmath>
namespace cg = cooperative_groups;

namespace pg8 {
#define PG8_LAS __attribute__((address_space(3)))
typedef unsigned short bf16_t;
typedef short bf16x8 __attribute__((ext_vector_type(8)));
typedef float f32x4 __attribute__((ext_vector_type(4)));
typedef unsigned u32x4 __attribute__((ext_vector_type(4)));
constexpr int BM = 256, BK = 64, HALF = 128, HTB = HALF * BK * 2  , STAGE_BYTES = 8 * HTB, NXCD = 8, WGM = 8;

__host__ __device__ __forceinline__ int lds_byte(int r, int c) { const int st = (r >> 4) * 2 + (c >> 5), rr = r & 15, cc = c & 31, ob = rr * 64 + cc * 2; return st * 1024 + (ob ^ (((ob >> 9) & 1) << 5)); }
__host__ __device__ __forceinline__ void stage_rc(int b, int& R, int& C) { const int st = b / 1024, sb = b % 1024, swz = sb ^ (((sb >> 9) & 1) << 5); R = (st >> 1) * 16 + swz / 64; C = (st & 1) * 32 + (swz % 64) / 2; }
__host__ __device__ __forceinline__ int perm32(int rho) { const int n = rho >> 4, i = rho & 15; return 8 * (i >> 2) + 4 * n + (i & 3); }

struct Unit { int pm, pn; };
struct Gemm { const bf16_t* A; const bf16_t* Bt; int M, N, K; };

struct StaticOrder {
    int nM, nN, nwg, G, c;
    __host__ __device__ void init(int M, int N, int G_, int c_) { nM = M / BM; nN = N / BM; nwg = nM * nN; G = G_; c = c_; }
    __host__ __device__ bool next(int i, Unit& u) const {
        const long L = (long)i * G + c; if (L >= nwg) return false;
        int wgid = (int)L; { const int q = nwg / NXCD, r = nwg % NXCD, xcd = wgid % NXCD, off = wgid / NXCD; wgid = (xcd < r ? xcd * (q + 1) : r * (q + 1) + (xcd - r) * q) + off; }
        const int nig = WGM * nN, gid = wgid / nig, fm = gid * WGM, gsz = (nM - fm) < WGM ? (nM - fm) : WGM;
        u.pm = fm + ((wgid % nig) % gsz); u.pn = (wgid % nig) / gsz; return true;
    }
    __device__ __forceinline__ void a_ready(const Unit&) const {}
    __device__ __forceinline__ void done(const Unit&) const {}
};

__device__ __forceinline__ unsigned cvt_pk_bf16(float lo, float hi) { unsigned r; asm volatile("v_cvt_pk_bf16_f32 %0, %1, %2" : "=v"(r) : "v"(lo), "v"(hi)); return r; }
constexpr float QSCALE = 0.125f * 1.4426950408889634f;

__device__ __forceinline__ float silu_mul(float g, float u) { return g * __builtin_amdgcn_rcpf(1.0f + __builtin_amdgcn_exp2f(-1.4426950408889634f * g)) * u; }

struct EpiSwiglu {
    static constexpr bool PERM = true, AFTER_DRAIN = false;
    bf16_t* H; int ldh;
    __device__ __forceinline__ void operator()(const f32x4 (&acc)[2][2][4][2], const Unit& u, int wr, int wc, int fr, int fq) const {
        const int row0 = u.pm * BM + wr * 64 + fr, col0 = u.pn * HALF + wc * 32 + 8 * fq;
#pragma unroll
        for (int ai = 0; ai < 2; ++ai)
#pragma unroll
            for (int m = 0; m < 4; ++m) {
                bf16_t* rowp = H + (size_t)(row0 + ai * HALF + m * 16) * ldh + col0;
                const f32x4 g0 = acc[ai][0][m][0], g1 = acc[ai][0][m][1], u0 = acc[ai][1][m][0], u1 = acc[ai][1][m][1];
                u32x4 w;
                w.x = cvt_pk_bf16(silu_mul(g0[0], u0[0]), silu_mul(g0[1], u0[1])); w.y = cvt_pk_bf16(silu_mul(g0[2], u0[2]), silu_mul(g0[3], u0[3]));
                w.z = cvt_pk_bf16(silu_mul(g1[0], u1[0]), silu_mul(g1[1], u1[1])); w.w = cvt_pk_bf16(silu_mul(g1[2], u1[2]), silu_mul(g1[3], u1[3]));
                *(u32x4*)rowp = w;
            }
    }
};

struct EpiPlain {
    static constexpr bool PERM = true, AFTER_DRAIN = false;
    bf16_t* O; int ldc;
    __device__ __forceinline__ void operator()(const f32x4 (&acc)[2][2][4][2], const Unit& u, int wr, int wc, int fr, int fq) const {
        const int row0 = u.pm * BM + wr * 64 + fr, col0 = u.pn * BM + wc * 32 + 8 * fq;
#pragma unroll
        for (int ai = 0; ai < 2; ++ai)
#pragma unroll
            for (int m = 0; m < 4; ++m) { bf16_t* rowp = O + (size_t)(row0 + ai * HALF + m * 16) * ldc + col0;
#pragma unroll
                for (int bj = 0; bj < 2; ++bj) { const f32x4 v0 = acc[ai][bj][m][0], v1 = acc[ai][bj][m][1];
                    u32x4 w; w.x = cvt_pk_bf16(v0[0], v0[1]); w.y = cvt_pk_bf16(v0[2], v0[3]); w.z = cvt_pk_bf16(v1[0], v1[1]); w.w = cvt_pk_bf16(v1[2], v1[3]);
                    *(u32x4*)(rowp + bj * HALF) = w; } }
    }
};

struct EpiInproj {
    static constexpr bool PERM = true, AFTER_DRAIN = false;
    bf16_t *Q, *Kb, *V, *QM; float* F; const float* rope; int do_rope;
    __device__ __forceinline__ void operator()(const f32x4 (&acc)[2][2][4][2], const Unit& u, int wr, int wc, int fr, int fq) const {
        const int pn = u.pn; const int row0 = u.pm * BM + wr * 64 + fr;
        if (pn == 10) {
            if (wc == 0 && fq < 2) {
#pragma unroll
                for (int ai = 0; ai < 2; ++ai)
#pragma unroll
                    for (int m = 0; m < 4; ++m) { float* fp = F + (size_t)(row0 + ai * HALF + m * 16) * 16 + 8 * fq; *(f32x4*)fp = acc[ai][0][m][0]; *(f32x4*)(fp + 4) = acc[ai][0][m][1]; }
            }
            return;
        }
        bf16_t* base; int ld, colt; float sc = 1.f;
        if (pn < 3) { base = Q; colt = pn * BM; ld = 768; sc = QSCALE; }
        else if (pn < 6) { base = Kb; colt = (pn - 3) * BM; ld = 768; }
        else if (pn < 9) { base = V; colt = (pn - 6) * BM; ld = 768; }
        else { base = QM; colt = 0; ld = 256; sc = QSCALE; }
        const bool rot = do_rope && pn < 6 && ((wc & 1) == 0);
        const int col0 = colt + wc * 32 + 8 * fq;
#pragma unroll
        for (int ai = 0; ai < 2; ++ai)
#pragma unroll
            for (int m = 0; m < 4; ++m) { const int row = row0 + ai * HALF + m * 16; bf16_t* rowp = base + (size_t)row * ld + col0;
#pragma unroll
                for (int bj = 0; bj < 2; ++bj) { f32x4 v0 = acc[ai][bj][m][0], v1 = acc[ai][bj][m][1];
                    if (rot) {
                        f32x4 w0, w1;
#pragma unroll
                        for (int j = 0; j < 4; ++j) { w0[j] = __shfl_xor(v0[j], 16); w1[j] = __shfl_xor(v1[j], 16); }
                        if (fq < 2) { const float* rp = rope + (size_t)(row & 4095) * 16;
                            const f32x4 c0 = *(const f32x4*)rp, c1 = *(const f32x4*)(rp + 4), s0 = *(const f32x4*)(rp + 8), s1 = *(const f32x4*)(rp + 12);
                            if (fq == 0) { v0 = v0 * c0 - w0 * s0; v1 = v1 * c1 - w1 * s1; } else { v0 = v0 * c0 + w0 * s0; v1 = v1 * c1 + w1 * s1; } }
                    }
                    v0 = v0 * sc; v1 = v1 * sc;
                    u32x4 w; w.x = cvt_pk_bf16(v0[0], v0[1]); w.y = cvt_pk_bf16(v0[2], v0[3]); w.z = cvt_pk_bf16(v1[0], v1[1]); w.w = cvt_pk_bf16(v1[2], v1[3]);
                    *(u32x4*)(rowp + bj * HALF) = w; } }
    }
};

struct EpiResid {
    static constexpr bool PERM = false, AFTER_DRAIN = false;
    const float* xin; float* y; int ldc; float alpha, s;
    __device__ __forceinline__ void operator()(const f32x4 (&acc)[2][2][4][2], const Unit& u, int wr, int wc, int fr, int fq) const {
        const int row0 = u.pm * BM + wr * 64 + fr, col0 = u.pn * BM + wc * 32 + 4 * fq;
#pragma unroll
        for (int ai = 0; ai < 2; ++ai)
#pragma unroll
            for (int m = 0; m < 4; ++m) { const size_t off = (size_t)(row0 + ai * HALF + m * 16) * ldc + col0;
#pragma unroll
                for (int bj = 0; bj < 2; ++bj)
#pragma unroll
                    for (int n = 0; n < 2; ++n) { const f32x4 xv = *(const f32x4*)(xin + off + bj * HALF + n * 16); *(f32x4*)(y + off + bj * HALF + n * 16) = xv * alpha + acc[ai][bj][m][n] * s; } }
    }
};

template <class Epi, class Sched, bool ALIGN_EPI = false, bool SP2 = false>
__device__ __forceinline__ void gemm_phase(PG8_LAS unsigned char* lds, const Gemm g, const Sched& S, const Epi& E) {
    int tid_o = threadIdx.x; asm volatile("" : "+v"(tid_o));
    const int tid = tid_o, wid = __builtin_amdgcn_readfirstlane(tid >> 6), lane = tid & 63, wr = wid >> 2, wc = wid & 3, fr = lane & 15, fq = lane >> 4;
    const int K = g.K, nt = K / BK;
    unsigned voffA[2], voffB[2];
#pragma unroll
    for (int i = 0; i < 2; ++i) { int R, C; stage_rc(tid * 16 + i * 8192, R, C); const int Rb = Epi::PERM ? ((R & ~31) + perm32(R & 31)) : R;
        voffA[i] = (unsigned)(R * K + C) * 2u; voffB[i] = (unsigned)(Rb * K + C) * 2u; }
    const size_t kstep = (size_t)(BK * 2);
    const size_t hstep = (size_t)HALF * K * 2;
    const size_t tstep = 2 * hstep;
    const unsigned ldsw = (unsigned)wid * 1024u;
    const int aoff = lds_byte(wr * 64 + fr, fq * 8), boff = lds_byte(wc * 32 + fr, fq * 8);
#define PG8_SA(b, h) (((b) * 2 + (h)) * HTB)
#define PG8_SB(b, h) ((4 + (b) * 2 + (h)) * HTB)
#define PG8_STAGE(bufoff, gbase, voff) do { _Pragma("unroll") for (int _i = 0; _i < 2; ++_i) \
        __builtin_amdgcn_global_load_lds((const unsigned*)((const char*)(gbase) + (voff)[_i]), (PG8_LAS unsigned*)(lds + (bufoff) + ldsw + _i * 8192), 16, 0, 0); } while (0)
#define PG8_LDA(dst, b, h) do { _Pragma("unroll") for (int m = 0; m < 4; ++m) _Pragma("unroll") for (int k = 0; k < 2; ++k) dst[m][k] = *(const PG8_LAS bf16x8*)(lds + PG8_SA(b, h) + aoff + m * 2048 + k * 1024); } while (0)
#define PG8_LDB(dst, b, h) do { _Pragma("unroll") for (int n = 0; n < 2; ++n) _Pragma("unroll") for (int k = 0; k < 2; ++k) dst[n][k] = *(const PG8_LAS bf16x8*)(lds + PG8_SB(b, h) + boff + n * 2048 + k * 1024); } while (0)
#define PG8_MMA(ai, bj, At, Bt) do { __builtin_amdgcn_s_setprio(1); _Pragma("unroll") for (int m = 0; m < 4; ++m) _Pragma("unroll") for (int n = 0; n < 2; ++n) _Pragma("unroll") for (int k = 0; k < 2; ++k) \
        acc[ai][bj][m][n] = __builtin_amdgcn_mfma_f32_16x16x32_bf16(Bt[n][k], At[m][k], acc[ai][bj][m][n], 0, 0, 0); __builtin_amdgcn_s_setprio(0); } while (0)
#define PG8_WAIT_V(n) asm volatile("s_waitcnt vmcnt(" #n ")" ::: "memory")
#define PG8_WAIT_L(n) asm volatile("s_waitcnt lgkmcnt(" #n ")" ::: "memory")
#define PG8_BAR __builtin_amdgcn_s_barrier()
#define PG8_SCHED __builtin_amdgcn_sched_barrier(0)
    Unit cur, nxt; int ui = 0;
    if (!S.next(0, cur)) return;
    f32x4 acc[2][2][4][2];
#pragma unroll
    for (int a = 0; a < 2; ++a)
#pragma unroll
        for (int b = 0; b < 2; ++b)
#pragma unroll
            for (int m = 0; m < 4; ++m)
#pragma unroll
                for (int n = 0; n < 2; ++n) acc[a][b][m][n] = (f32x4){0.f, 0.f, 0.f, 0.f};
    bf16x8 At[4][2], B0[2][2], B1[2][2];
    const char* cA = (const char*)g.A + (size_t)cur.pm * tstep; const char* cB = (const char*)g.Bt + (size_t)cur.pn * tstep;
    S.a_ready(cur);
    if constexpr (SP2) {
        PG8_STAGE(PG8_SB(0, 0), cB, voffB); PG8_STAGE(PG8_SB(0, 1), cB + hstep, voffB); PG8_STAGE(PG8_SA(0, 0), cA, voffA); PG8_STAGE(PG8_SA(0, 1), cA + hstep, voffA);
        if (wr == 1) PG8_BAR;
        PG8_WAIT_V(2); PG8_BAR;
        PG8_STAGE(PG8_SB(1, 0), cB + kstep, voffB); PG8_STAGE(PG8_SA(1, 0), cA + kstep, voffA); PG8_STAGE(PG8_SB(1, 1), cB + hstep + kstep, voffB);
        PG8_WAIT_V(6); PG8_BAR;
    } else {
        PG8_STAGE(PG8_SB(0, 0), cB, voffB); PG8_STAGE(PG8_SA(0, 0), cA, voffA); PG8_STAGE(PG8_SB(0, 1), cB + hstep, voffB); PG8_STAGE(PG8_SA(0, 1), cA + hstep, voffA);
        if (wr == 1) PG8_BAR;
        PG8_WAIT_V(4); PG8_BAR;
        PG8_STAGE(PG8_SB(1, 0), cB + kstep, voffB); PG8_STAGE(PG8_SA(1, 0), cA + kstep, voffA); PG8_STAGE(PG8_SB(1, 1), cB + hstep + kstep, voffB);
        PG8_WAIT_V(6); PG8_BAR;
    }
    for (;;) {
        const bool has_next = S.next(ui + 1, nxt);
        const char* nA = has_next ? (const char*)g.A + (size_t)nxt.pm * tstep : cA; const char* nB = has_next ? (const char*)g.Bt + (size_t)nxt.pn * tstep : cB;
        for (int t = 0; t < nt; t += 2) {
            const bool last = (t == nt - 2);
            const char* a1 = cA + (size_t)(t + 1) * kstep;
            const char* a2 = last ? nA : cA + (size_t)(t + 2) * kstep; const char* b2 = last ? nB : cB + (size_t)(t + 2) * kstep;
            const char* a3 = a2 + kstep; const char* b3 = b2 + kstep;
            if (last && has_next) S.a_ready(nxt);
            if constexpr (SP2) {
            PG8_LDB(B0, 0, 0); PG8_LDB(B1, 0, 1); PG8_SCHED; PG8_LDA(At, 0, 0); PG8_STAGE(PG8_SA(1, 1), a1 + hstep, voffA);
            PG8_WAIT_V(8); PG8_WAIT_L(0); PG8_BAR; PG8_MMA(0, 0, At, B0); PG8_MMA(0, 1, At, B1); PG8_BAR; PG8_SCHED;
            PG8_LDA(At, 0, 1); PG8_STAGE(PG8_SB(0, 0), b2, voffB); PG8_STAGE(PG8_SB(0, 1), b2 + hstep, voffB); PG8_STAGE(PG8_SA(0, 0), a2, voffA);
            PG8_WAIT_V(8); PG8_WAIT_L(0); PG8_BAR; PG8_MMA(1, 0, At, B0); PG8_MMA(1, 1, At, B1); PG8_BAR; PG8_SCHED;
            PG8_LDB(B0, 1, 0); PG8_LDB(B1, 1, 1); PG8_SCHED; PG8_LDA(At, 1, 0); PG8_STAGE(PG8_SA(0, 1), a2 + hstep, voffA);
            PG8_WAIT_V(8); PG8_WAIT_L(0); PG8_BAR; PG8_MMA(0, 0, At, B0); PG8_MMA(0, 1, At, B1); PG8_BAR; PG8_SCHED;
            PG8_LDA(At, 1, 1); PG8_STAGE(PG8_SB(1, 0), b3, voffB); PG8_STAGE(PG8_SB(1, 1), b3 + hstep, voffB); PG8_STAGE(PG8_SA(1, 0), a3, voffA);
            PG8_WAIT_V(8); PG8_WAIT_L(0); PG8_BAR; PG8_MMA(1, 0, At, B0); PG8_MMA(1, 1, At, B1); PG8_BAR; PG8_SCHED;
            } else {
            PG8_LDB(B0, 0, 0); PG8_SCHED; PG8_LDA(At, 0, 0); PG8_STAGE(PG8_SA(1, 1), a1 + hstep, voffA);
            PG8_WAIT_L(8); PG8_BAR; PG8_WAIT_L(0); PG8_MMA(0, 0, At, B0); PG8_BAR; PG8_SCHED;
            PG8_LDB(B1, 0, 1); PG8_STAGE(PG8_SB(0, 0), b2, voffB);
            PG8_BAR; PG8_WAIT_L(0); PG8_MMA(0, 1, At, B1); PG8_BAR;
            PG8_LDA(At, 0, 1); PG8_STAGE(PG8_SA(0, 0), a2, voffA);
            PG8_BAR; PG8_WAIT_L(0); PG8_MMA(1, 0, At, B0); PG8_BAR; PG8_SCHED;
            PG8_STAGE(PG8_SB(0, 1), b2 + hstep, voffB);
            PG8_WAIT_V(6); PG8_BAR; PG8_MMA(1, 1, At, B1); PG8_BAR;
            PG8_LDB(B0, 1, 0); PG8_SCHED; PG8_LDA(At, 1, 0); PG8_STAGE(PG8_SA(0, 1), a2 + hstep, voffA);
            PG8_WAIT_L(8); PG8_BAR; PG8_WAIT_L(0); PG8_MMA(0, 0, At, B0); PG8_BAR; PG8_SCHED;
            PG8_LDB(B1, 1, 1); PG8_STAGE(PG8_SB(1, 0), b3, voffB);
            PG8_BAR; PG8_WAIT_L(0); PG8_MMA(0, 1, At, B1); PG8_BAR;
            PG8_LDA(At, 1, 1); PG8_STAGE(PG8_SA(1, 0), a3, voffA);
            PG8_BAR; PG8_WAIT_L(0); PG8_MMA(1, 0, At, B0); PG8_BAR; PG8_SCHED;
            PG8_STAGE(PG8_SB(1, 1), b3 + hstep, voffB);
            PG8_WAIT_V(6); PG8_BAR; PG8_MMA(1, 1, At, B1); PG8_BAR;
            }
        }
        if constexpr (ALIGN_EPI) { if (wr == 0) PG8_BAR; }
        if constexpr (!Epi::AFTER_DRAIN) { E(acc, cur, wr, wc, fr, fq); S.done(cur); }
        if (!has_next) break;
#pragma unroll
        for (int a = 0; a < 2; ++a)
#pragma unroll
            for (int b = 0; b < 2; ++b)
#pragma unroll
                for (int m = 0; m < 4; ++m)
#pragma unroll
                    for (int n = 0; n < 2; ++n) acc[a][b][m][n] = (f32x4){0.f, 0.f, 0.f, 0.f};
        cur = nxt; cA = nA; cB = nB; ++ui;
        if constexpr (ALIGN_EPI) { if (wr == 1) PG8_BAR; }
    }
    PG8_WAIT_V(0);
    if constexpr (!ALIGN_EPI) { if (wr == 0) PG8_BAR; }
    PG8_BAR;
    if constexpr (Epi::AFTER_DRAIN) { E.fused(acc, cur, wr, wc, fr, fq, lds, wid, lane); S.done(cur); }
#undef PG8_SA
#undef PG8_SB
#undef PG8_STAGE
#undef PG8_LDA
#undef PG8_LDB
#undef PG8_MMA
#undef PG8_WAIT_V
#undef PG8_WAIT_L
#undef PG8_BAR
#undef PG8_SCHED
}
}

#define LAS __attribute__((address_space(3)))
typedef unsigned short bf16;
typedef float f32x4 __attribute__((ext_vector_type(4)));
typedef float f32x16 __attribute__((ext_vector_type(16)));
typedef short bf16x8 __attribute__((ext_vector_type(8)));
typedef short s16x4 __attribute__((ext_vector_type(4)));
typedef unsigned u32x4 __attribute__((ext_vector_type(4)));
typedef unsigned u32x2 __attribute__((ext_vector_type(2)));

constexpr int BATCH = 8, SEQ = 4096, D = 1024, FF = 2816, M = BATCH * SEQ;
constexpr int MEMLEN = 256, MROWS = BATCH * MEMLEN;
constexpr int NIN_A = 2560, NIN_B = 2816;
constexpr float LN_EPS = 1e-5f, DN_ALPHA = 1.4142135623730951f, LOG2E = 1.4426950408889634f;
constexpr int NWAVES = 8;

constexpr size_t MiB = 1u << 20;
constexpr size_t WS_ROPE = 1 * MiB;
constexpr size_t WS_F = 2 * MiB;
constexpr size_t WS_LSE = 4 * MiB;
constexpr size_t WS_MEMB = 6 * MiB;
constexpr size_t WS_MEMKV = 10 * MiB;
constexpr size_t WS_WGU = 16 * MiB;
constexpr size_t WS_WD = 60 * MiB;
constexpr size_t WS_WINA = 82 * MiB, WS_WINB = 87 * MiB, WS_WOUTA = 93 * MiB, WS_WOUTB = 94 * MiB, WS_WKV = 96 * MiB;
constexpr size_t WS_XB = 100 * MiB;
constexpr size_t WS_H = 164 * MiB;
constexpr size_t WS_Q = WS_H, WS_K = WS_H + 48 * MiB, WS_V = WS_H + 96 * MiB, WS_QM = WS_H + 144 * MiB;
constexpr size_t WS_OG = 340 * MiB;
constexpr size_t WS_END = 388 * MiB;

constexpr int RING_BYTES = 131072, LDS_BYTES = 147456;
constexpr int FOX_K = 0, FOX_V = 16384, FOX_VS = 136, FOX_VBYTES = 64 * FOX_VS, FOX_CS = 34816, FOX_WS = 51200;
constexpr int WL_STRIDE = 9216, WL_V = 4096, WL_VS = 72;

struct TJob { const float* src; bf16* dst; int ld, col0, ncols, K, nblk, mode, item0, pad; };
constexpr int NJOBS = 17;
struct Args { const float* in[14]; float* out; unsigned char* ws; TJob jobs[NJOBS]; int njobs, nitems; };

struct Frame {
    int tid, lane, wave, vcu, G;
    unsigned char* ws; float* out;
    const float *x, *ln_gain, *ln_bias, *fbias;
#define FR_PTR(name, T, off) __device__ __forceinline__ T* name() const { return (T*)(ws + (off)); }
    FR_PTR(xb, bf16, WS_XB) FR_PTR(Hb, bf16, WS_H) FR_PTR(Qb, bf16, WS_Q) FR_PTR(Kb, bf16, WS_K) FR_PTR(Vb, bf16, WS_V) FR_PTR(QMb, bf16, WS_QM)
    FR_PTR(OG, bf16, WS_OG) FR_PTR(memb, bf16, WS_MEMB) FR_PTR(memkv, bf16, WS_MEMKV)
    FR_PTR(Wgu, bf16, WS_WGU) FR_PTR(Wd, bf16, WS_WD) FR_PTR(Wina, bf16, WS_WINA) FR_PTR(Winb, bf16, WS_WINB) FR_PTR(Wouta, bf16, WS_WOUTA) FR_PTR(Woutb, bf16, WS_WOUTB) FR_PTR(Wkv, bf16, WS_WKV)
    FR_PTR(rope, float, WS_ROPE) FR_PTR(Flog, float, WS_F) FR_PTR(Lse, float, WS_LSE)
#undef FR_PTR
};

__device__ __forceinline__ int crow(int r, int hi) { return (r & 3) + 8 * (r >> 2) + 4 * hi; }
__device__ __forceinline__ unsigned f2bf(float f) { unsigned u = __builtin_bit_cast(unsigned, f); return (u + 0x7fffu + ((u >> 16) & 1u)) >> 16; }
__device__ __forceinline__ unsigned pk2(float lo, float hi) { return f2bf(lo) | (f2bf(hi) << 16); }
__device__ __forceinline__ float bf2f(unsigned h) { return __builtin_bit_cast(float, h << 16); }

template <int NKH, bool BIAS, bool MASKED>
__device__ __forceinline__ void tile_step(LAS const unsigned char* Kt, LAS const unsigned char* Vt, const int vstride, const bf16x8 (&qf)[4], f32x16 (&o)[2], float& m, float& lsum,
                                          const float cq, LAS const float* ck, const int dmin, const int dmax, const int lane) {
    const int kk = lane & 31, hi = lane >> 5;
    f32x16 p[NKH];
#pragma unroll
    for (int kh = 0; kh < NKH; ++kh) {
        f32x16 c;
#pragma unroll
        for (int r = 0; r < 16; ++r) c[r] = BIAS ? cq : 0.f;
        const int key = 32 * kh + kk, sw = (key >> 1) & 7;
        LAS const unsigned char* kp = Kt + key * 128;
#pragma unroll
        for (int d0 = 0; d0 < 4; ++d0) { const bf16x8 a = *(LAS const bf16x8*)(kp + (((2 * d0 + hi) ^ sw) << 4)); c = __builtin_amdgcn_mfma_f32_32x32x16_bf16(a, qf[d0], c, 0, 0, 0); }
        p[kh] = c;
    }
    if (BIAS) {
#pragma unroll
        for (int kh = 0; kh < NKH; ++kh)
#pragma unroll
            for (int g = 0; g < 4; ++g) { const f32x4 cv = *(LAS const f32x4*)(ck + 32 * kh + 8 * g + 4 * hi);
#pragma unroll
                for (int j = 0; j < 4; ++j) p[kh][4 * g + j] -= cv[j]; }
    }
    if (MASKED) {
#pragma unroll
        for (int kh = 0; kh < NKH; ++kh)
#pragma unroll
            for (int r = 0; r < 16; ++r) { const int dd = 32 * kh + crow(r, hi) - kk; if (dd < dmin || dd > dmax) p[kh][r] = -INFINITY; }
    }
    float mx = p[0][0];
#pragma unroll
    for (int kh = 0; kh < NKH; ++kh)
#pragma unroll
        for (int r = 0; r < 16; ++r) mx = fmaxf(mx, p[kh][r]);
    mx = fmaxf(mx, __shfl_xor(mx, 32));
    const float mnew = fmaxf(m, mx), muse = (mnew == -INFINITY) ? 0.f : mnew;
    const float alpha = __builtin_amdgcn_exp2f(m - muse);
    m = mnew;
    float s = 0.f;
#pragma unroll
    for (int kh = 0; kh < NKH; ++kh)
#pragma unroll
        for (int r = 0; r < 16; ++r) { const float e = __builtin_amdgcn_exp2f(p[kh][r] - muse); p[kh][r] = e; s += e; }
    lsum = lsum * alpha + s;
    if (__any(alpha != 1.f)) {
#pragma unroll
        for (int dh = 0; dh < 2; ++dh)
#pragma unroll
            for (int r = 0; r < 16; ++r) o[dh][r] *= alpha;
    }
#pragma unroll
    for (int ks = 0; ks < 2 * NKH; ++ks) {
        const int kh = ks >> 1, rb = 8 * (ks & 1);
        u32x4 pw; pw.x = pg8::cvt_pk_bf16(p[kh][rb], p[kh][rb + 1]); pw.y = pg8::cvt_pk_bf16(p[kh][rb + 2], p[kh][rb + 3]); pw.z = pg8::cvt_pk_bf16(p[kh][rb + 4], p[kh][rb + 5]); pw.w = pg8::cvt_pk_bf16(p[kh][rb + 6], p[kh][rb + 7]);
        const bf16x8 pb = __builtin_bit_cast(bf16x8, pw);
#pragma unroll
        for (int dh = 0; dh < 2; ++dh) {
            LAS const unsigned char* vp = Vt + (32 * dh + kk) * vstride + (16 * ks + 4 * hi) * 2;
            const s16x4 lo = *(LAS const s16x4*)vp, h4 = *(LAS const s16x4*)(vp + 16);
            const bf16x8 a = (bf16x8){lo[0], lo[1], lo[2], lo[3], h4[0], h4[1], h4[2], h4[3]};
            o[dh] = __builtin_amdgcn_mfma_f32_32x32x16_bf16(a, pb, o[dh], 0, 0, 0);
        }
    }
}

__device__ __forceinline__ void store_o(const f32x16 (&o)[2], float inv, bf16* rowp, int hi) {
#pragma unroll
    for (int dh = 0; dh < 2; ++dh)
#pragma unroll
        for (int g = 0; g < 4; ++g) { u32x2 w; w.x = pg8::cvt_pk_bf16(o[dh][4 * g] * inv, o[dh][4 * g + 1] * inv); w.y = pg8::cvt_pk_bf16(o[dh][4 * g + 2] * inv, o[dh][4 * g + 3] * inv);
            *(u32x2*)(rowp + 32 * dh + 8 * g + 4 * hi) = w; }
}

__device__ __forceinline__ void fox_scan(const Frame& F, int b, int h, LAS unsigned char* lds) {
    LAS float* cs = (LAS float*)(lds + FOX_CS); LAS float* wsum = (LAS float*)(lds + FOX_WS);
    const int t = F.tid; const float bias = F.fbias[h];
    const float* fp = F.Flog() + ((size_t)b * SEQ + 8 * t) * 16 + h;
    float v[8]; float run = 0.f;
#pragma unroll
    for (int j = 0; j < 8; ++j) { const float z = fp[j * 16] + bias; const float ls = fminf(z, 0.f) - log1pf(expf(-fabsf(z))); run += ls; v[j] = run; }
    float inc = run;
#pragma unroll
    for (int o = 1; o < 64; o <<= 1) { const float y = __shfl_up(inc, o); if (F.lane >= o) inc += y; }
    if (F.lane == 63) wsum[F.wave] = inc;
    __syncthreads();
    float off = inc - run;
    for (int ww = 0; ww < F.wave; ++ww) off += wsum[ww];
    f32x4 a, c2;
    a.x = (off + v[0]) * LOG2E; a.y = (off + v[1]) * LOG2E; a.z = (off + v[2]) * LOG2E; a.w = (off + v[3]) * LOG2E;
    c2.x = (off + v[4]) * LOG2E; c2.y = (off + v[5]) * LOG2E; c2.z = (off + v[6]) * LOG2E; c2.w = (off + v[7]) * LOG2E;
    *(LAS f32x4*)(cs + 8 * t) = a; *(LAS f32x4*)(cs + 8 * t + 4) = c2;
    __syncthreads();
}

__device__ __forceinline__ void fox_unit(const Frame& F, int b, int h, int qb, bf16* cat, int ldcat, LAS unsigned char* lds) {
    const int tid = F.tid, lane = F.lane, w = F.wave, kk = lane & 31, hi = lane >> 5;
    LAS const float* cs = (LAS const float*)(lds + FOX_CS);
    const size_t rowb = (size_t)b * SEQ;
    const int q0 = qb * 256 + w * 32;
    const bf16* qp = F.Qb() + (rowb + q0 + kk) * 768 + h * 64 + hi * 8;
    bf16x8 qf[4];
#pragma unroll
    for (int d0 = 0; d0 < 4; ++d0) qf[d0] = *(const bf16x8*)(qp + 16 * d0);
    const float cq = cs[q0 + kk];
    f32x16 o[2]; o[0] = f32x16{}; o[1] = f32x16{};
    float m = -INFINITY, lsum = 0.f;
    const int NT = 4 * (qb + 1);
    const int key_t = tid >> 3, chunk = tid & 7;
    const bf16* kg = F.Kb() + (rowb + key_t) * 768 + h * 64 + chunk * 8;
    const bf16* vg = F.Vb() + (rowb + key_t) * 768 + h * 64 + chunk * 8;
    const int kdst = key_t * 128 + ((chunk ^ ((key_t >> 1) & 7)) << 4);
    const int vdst = (8 * chunk) * FOX_VS + key_t * 2;
    u32x4 kr = *(const u32x4*)kg, vr = *(const u32x4*)vg;
#define FOX_STAGE(buf) do { *(LAS u32x4*)(lds + FOX_K + (buf) * 8192 + kdst) = kr; \
        LAS unsigned short* vt_ = (LAS unsigned short*)(lds + FOX_V + (buf) * FOX_VBYTES + vdst); \
        _Pragma("unroll") for (int j_ = 0; j_ < 8; ++j_) vt_[j_ * (FOX_VS / 2)] = (unsigned short)(vr[j_ >> 1] >> (16 * (j_ & 1))); } while (0)
    FOX_STAGE(0);
    __syncthreads();
    for (int t = 0; t < NT; ++t) {
        const bool more = (t + 1 < NT);
        if (more) { kr = *(const u32x4*)(kg + (size_t)(t + 1) * 64 * 768); vr = *(const u32x4*)(vg + (size_t)(t + 1) * 64 * 768); }
        const int jb = t - (NT - 4);
        LAS const unsigned char* Kt = lds + FOX_K + (t & 1) * 8192; LAS const unsigned char* Vt = lds + FOX_V + (t & 1) * FOX_VBYTES;
        if (jb < 0) tile_step<2, true, false>(Kt, Vt, FOX_VS, qf, o, m, lsum, cq, cs + 64 * t, 0, 0, lane);
        else if (64 * jb <= 32 * w + 31) tile_step<2, true, true>(Kt, Vt, FOX_VS, qf, o, m, lsum, cq, cs + 64 * t, -100000, 32 * w - 64 * jb, lane);
        if (more) FOX_STAGE((t + 1) & 1);
        __syncthreads();
    }
#undef FOX_STAGE
    const float lt = lsum + __shfl_xor(lsum, 32);
    store_o(o, 1.0f / lt, cat + (rowb + q0 + kk) * ldcat + h * 64, hi);
}

template <bool DIL>
__device__ __forceinline__ void wave_item(const Frame& F, int item, const bf16* memkv_l, bf16* cat, int ldcat, int catoff, LAS unsigned char* wl) {
    const int lane = F.lane, kk = lane & 31, hi = lane >> 5, chunk = lane & 7, ksub = lane >> 3;
    int b, hd, r = 1, rho = 0, i0 = 0;
    if (DIL) { b = item / 1536; const int rem = item % 1536; hd = rem >> 7; const int idx = rem & 127; const int g = hd >> 2; r = 1 << (2 * g); const int l32 = 128 >> (2 * g); rho = idx / l32; i0 = 32 * (idx % l32); }
    else { b = item / 512; const int rem = item % 512; hd = rem >> 7; i0 = 32 * (rem & 127); }
    const size_t rowb = (size_t)b * SEQ;
    const size_t qrow = DIL ? rowb + (size_t)(i0 + kk) * r + rho : rowb + i0 + kk;
    const bf16* qp = DIL ? F.Qb() + qrow * 768 + hd * 64 + hi * 8 : F.QMb() + qrow * 256 + hd * 64 + hi * 8;
    bf16x8 qf[4];
#pragma unroll
    for (int d0 = 0; d0 < 4; ++d0) qf[d0] = *(const bf16x8*)(qp + 16 * d0);
    f32x16 o[2]; o[0] = f32x16{}; o[1] = f32x16{};
    float m = -INFINITY, lsum = 0.f;
    const int kt0 = DIL ? (i0 >= 128 ? 0 : (128 - i0) >> 5) : 0, kte = DIL ? 5 : 8;
    const bf16* Kbase = DIL ? F.Kb() + hd * 64 + chunk * 8 : memkv_l + hd * 64 + chunk * 8;
    const bf16* Vbase = DIL ? F.Vb() + hd * 64 + chunk * 8 : memkv_l + 256 + hd * 64 + chunk * 8;
    u32x4 kr[4], vr[4];
#define WI_LOAD(kt) do { _Pragma("unroll") for (int i_ = 0; i_ < 4; ++i_) { const int key_ = 8 * i_ + ksub; \
        const size_t ro_ = DIL ? (rowb + (size_t)(i0 - 128 + 32 * (kt) + key_) * r + rho) * 768 : ((size_t)b * MEMLEN + 32 * (kt) + key_) * 512; \
        kr[i_] = *(const u32x4*)(Kbase + ro_); vr[i_] = *(const u32x4*)(Vbase + ro_); } } while (0)
#define WI_STAGE() do { _Pragma("unroll") for (int i_ = 0; i_ < 4; ++i_) { const int key_ = 8 * i_ + ksub; \
        *(LAS u32x4*)(wl + key_ * 128 + ((chunk ^ ((key_ >> 1) & 7)) << 4)) = kr[i_]; \
        LAS unsigned short* vt_ = (LAS unsigned short*)(wl + WL_V + (8 * chunk) * WL_VS + key_ * 2); \
        _Pragma("unroll") for (int j_ = 0; j_ < 8; ++j_) vt_[j_ * (WL_VS / 2)] = (unsigned short)(vr[i_][j_ >> 1] >> (16 * (j_ & 1))); } } while (0)
    WI_LOAD(kt0);
    for (int kt = kt0; kt < kte; ++kt) {
        asm volatile("" ::: "memory");
        WI_STAGE();
        if (kt + 1 < kte) WI_LOAD(kt + 1);
        asm volatile("" ::: "memory");
        if (DIL && (kt == 0 || kt == 4)) tile_step<1, false, true>(wl, wl + WL_V, WL_VS, qf, o, m, lsum, 0.f, nullptr, kt == 0 ? 0 : -100000, kt == 0 ? 100000 : 0, lane);
        else tile_step<1, false, false>(wl, wl + WL_V, WL_VS, qf, o, m, lsum, 0.f, nullptr, 0, 0, lane);
        asm volatile("" ::: "memory");
    }
#undef WI_LOAD
#undef WI_STAGE
    const float lt = lsum + __shfl_xor(lsum, 32);
    if (DIL) {
        store_o(o, 1.0f / lt, F.OG() + qrow * 768 + hd * 64, hi);
        if (hi == 0) F.Lse()[qrow * 16 + hd] = m + __builtin_amdgcn_logf(lt);
    } else {
        store_o(o, 1.0f / lt, cat + qrow * ldcat + catoff + hd * 64, hi);
    }
}

__device__ __forceinline__ void combine_phase(const Frame& F, bf16* cat) {
    const int gt = F.vcu * (NWAVES * 64) + F.tid, NT = F.G * NWAVES * 64;
    for (int idx = gt; idx < M * 32; idx += NT) {
        const int row = idx >> 5, ch = idx & 31, h = ch >> 3;
        const float l0 = F.Lse()[(size_t)row * 16 + h], l1 = F.Lse()[(size_t)row * 16 + 4 + h], l2 = F.Lse()[(size_t)row * 16 + 8 + h];
        const float mx = fmaxf(l0, fmaxf(l1, l2));
        float w0 = __builtin_amdgcn_exp2f(l0 - mx), w1 = __builtin_amdgcn_exp2f(l1 - mx), w2 = __builtin_amdgcn_exp2f(l2 - mx);
        const float inv = 1.0f / (w0 + w1 + w2); w0 *= inv; w1 *= inv; w2 *= inv;
        const bf16* og = F.OG() + (size_t)row * 768 + h * 64 + (ch & 7) * 8;
        const u32x4 a0 = *(const u32x4*)og, a1 = *(const u32x4*)(og + 256), a2 = *(const u32x4*)(og + 512);
        u32x4 ov;
#pragma unroll
        for (int j = 0; j < 4; ++j) {
            const float lo = w0 * bf2f(a0[j] & 0xffffu) + w1 * bf2f(a1[j] & 0xffffu) + w2 * bf2f(a2[j] & 0xffffu);
            const float hi = w0 * bf2f(a0[j] >> 16) + w1 * bf2f(a1[j] >> 16) + w2 * bf2f(a2[j] >> 16);
            ov[j] = pk2(lo, hi);
        }
        *(u32x4*)(cat + (size_t)row * 512 + ch * 8) = ov;
    }
}

__device__ __forceinline__ float wave_sum(float v) {
#pragma unroll
    for (int o = 1; o < 64; o <<= 1) v += __shfl_xor(v, o);
    return v;
}
__device__ __forceinline__ void transpose_item(const TJob& J, int item, LAS float* scr, int lane) {
    const int kb = item / J.nblk, nb = item % J.nblk, k0 = 64 * kb, n0 = 32 * nb;
    const int nl = lane & 31; const bool okc = (n0 + nl) < J.ncols;
    const float* sp = J.src + (size_t)k0 * J.ld + J.col0 + n0 + nl;
#pragma unroll 8
    for (int i = 0; i < 32; ++i) { const int kk = 2 * i + (lane >> 5); scr[kk * 33 + nl] = okc ? sp[(size_t)kk * J.ld] : 0.f; }
    asm volatile("s_waitcnt lgkmcnt(0)" ::: "memory");
    int drow0 = n0;
    if (J.mode == 1) { drow0 = (n0 < FF) ? ((n0 >> 7) * 256 + (n0 & 127)) : ((((n0 - FF) >> 7) * 256) + 128 + ((n0 - FF) & 127)); }
    const int c = lane & 7;
#pragma unroll
    for (int j = 0; j < 4; ++j) { const int n = (lane >> 3) + 8 * j; const LAS float* s = scr + (8 * c) * 33 + n;
        u32x4 o; o.x = pk2(s[0 * 33], s[1 * 33]); o.y = pk2(s[2 * 33], s[3 * 33]); o.z = pk2(s[4 * 33], s[5 * 33]); o.w = pk2(s[6 * 33], s[7 * 33]);
        *(u32x4*)(J.dst + (size_t)(drow0 + n) * J.K + k0 + 8 * c) = o; }
    asm volatile("s_waitcnt lgkmcnt(0)" ::: "memory");
}
__device__ __forceinline__ void cvt_rows(const float* src, bf16* dst, size_t n8, size_t gt, size_t NT) {
    for (size_t i = gt; i < n8; i += NT) { const f32x4 a = *(const f32x4*)(src + 8 * i), b = *(const f32x4*)(src + 8 * i + 4);
        u32x4 o; o.x = pk2(a.x, a.y); o.y = pk2(a.z, a.w); o.z = pk2(b.x, b.y); o.w = pk2(b.z, b.w); *(u32x4*)(dst + 8 * i) = o; }
}
__device__ __forceinline__ void prologue(const Frame& F, const Args& args, LAS unsigned char* lds) {
    LAS float* scr = (LAS float*)(lds + F.wave * 16384);
    const int gw = F.vcu * NWAVES + F.wave, NGW = F.G * NWAVES;
    for (int it = gw; it < args.nitems; it += NGW) {
        int j = 0;
        while (j + 1 < args.njobs && it >= args.jobs[j + 1].item0) ++j;
        const TJob J = args.jobs[j];
        transpose_item(J, it - J.item0, scr, F.lane);
    }
    const size_t gt = (size_t)F.vcu * (NWAVES * 64) + F.tid, NT = (size_t)F.G * NWAVES * 64;
    cvt_rows(F.x, F.xb(), (size_t)M * D / 8, gt, NT);
    cvt_rows(args.in[1], F.memb(), (size_t)MROWS * D / 8, gt, NT);
    for (size_t i = gt; i < (size_t)SEQ * 8; i += NT) {
        const int pos = (int)(i >> 3), j = (int)(i & 7);
        const double f = j == 0 ? 1.0 : j == 1 ? 0.19392274474868576 : j == 2 ? 0.03760603093086393 : j == 3 ? 0.007292664737217109 : j == 4 ? 0.001414213562373095 : j == 5 ? 0.0002742481756762073 : j == 6 ? 5.318295896944988e-05 : 1.031338537721246e-05;
        const float af = (float)pos * (float)f;
        const double a = (double)af;
        const double k = rint(a * 0.15915494309189535);
        const double rr = a - k * 6.283185307179586;
        const double r2 = rr * rr; double s = 1.0, c = 1.0;
#pragma unroll
        for (int q = 12; q >= 1; --q) { s = 1.0 - s * r2 * (1.0 / (double)((2 * q) * (2 * q + 1))); c = 1.0 - c * r2 * (1.0 / (double)((2 * q - 1) * (2 * q))); }
        F.rope()[(size_t)pos * 16 + j] = (float)c; F.rope()[(size_t)pos * 16 + 8 + j] = (float)(rr * s);
    }
}

__device__ __forceinline__ void ln_phase(const Frame& F, const float* g, const float* bta, bool write_xb) {
    const int gw = F.vcu * NWAVES + F.wave, NGW = F.G * NWAVES;
    f32x4 gv[4], bv[4];
#pragma unroll
    for (int j = 0; j < 4; ++j) { gv[j] = *(const f32x4*)(g + 4 * (64 * j + F.lane)); bv[j] = *(const f32x4*)(bta + 4 * (64 * j + F.lane)); }
    for (int row = gw; row < M; row += NGW) {
        float* yr = F.out + (size_t)row * D;
        f32x4 v[4]; float s = 0.f;
#pragma unroll
        for (int j = 0; j < 4; ++j) { v[j] = *(const f32x4*)(yr + 4 * (64 * j + F.lane)); s += (v[j].x + v[j].y) + (v[j].z + v[j].w); }
        const float mean = wave_sum(s) * (1.f / D); float s2 = 0.f;
#pragma unroll
        for (int j = 0; j < 4; ++j) { v[j] = v[j] - mean; s2 += (v[j].x * v[j].x + v[j].y * v[j].y) + (v[j].z * v[j].z + v[j].w * v[j].w); }
        const float rstd = 1.f / sqrtf(wave_sum(s2) * (1.f / D) + LN_EPS);
#pragma unroll
        for (int j = 0; j < 4; ++j) { const f32x4 ov = v[j] * rstd * gv[j] + bv[j]; *(f32x4*)(yr + 4 * (64 * j + F.lane)) = ov;
            if (write_xb) { u32x2 w; w.x = pk2(ov.x, ov.y); w.y = pk2(ov.z, ov.w); *(u32x2*)(F.xb() + (size_t)row * D + 4 * (64 * j + F.lane)) = w; } }
    }
}

__global__ void __launch_bounds__(NWAVES * 64, 2) fwd_kernel(Args args) {
    extern __shared__ __attribute__((aligned(16))) unsigned char lds_raw[];
    LAS unsigned char* lds = (LAS unsigned char*)lds_raw;
    cg::grid_group grid = cg::this_grid();
    Frame F;
    F.tid = threadIdx.x; F.lane = F.tid & 63; F.wave = __builtin_amdgcn_readfirstlane(F.tid >> 6);
    F.G = gridDim.x; { const int bx = blockIdx.x; F.vcu = (F.G % 8 == 0) ? (bx % 8) * (F.G / 8) + bx / 8 : bx; }
    F.ws = args.ws; F.out = args.out; F.x = args.in[0]; F.ln_gain = args.in[6]; F.ln_bias = args.in[7]; F.fbias = args.in[12];
    const int bx = (int)blockIdx.x;


#ifndef T_NO_PRO
    prologue(F, args, lds);
#endif

    grid.sync();

#pragma unroll 1
    for (int l = 0; l < 2; ++l) {
        pg8::Gemm g{F.memb(), F.Wkv() + (size_t)l * 512 * 1024, MROWS, 512, D}; pg8::StaticOrder S; S.init(MROWS, 512, F.G, (bx + F.G - 16 * l) % F.G);
        pg8::EpiPlain E{F.memkv() + (size_t)l * MROWS * 512, 512};
        pg8::gemm_phase<pg8::EpiPlain, pg8::StaticOrder, true, true>(lds, g, S, E);
    }

#pragma unroll 1
    for (int sub = 0; sub < 6; ++sub) {
        const int layer = sub / 3, kind = sub % 3;
        { int t_ = threadIdx.x; asm volatile("" : "+v"(t_)); F.tid = t_; F.lane = t_ & 63; F.wave = __builtin_amdgcn_readfirstlane(t_ >> 6); }
        const float* xin = (sub == 0) ? F.x : F.out;
        if (kind != 1) {
            const int e = (kind == 0 ? 0 : 2) + layer;
            { pg8::Gemm g{F.xb(), F.Wgu() + (size_t)e * 2 * FF * D, M, 2 * FF, D}; pg8::StaticOrder S; S.init(M, 2 * FF, F.G, bx);
              pg8::EpiSwiglu E{F.Hb(), FF};
              pg8::gemm_phase<pg8::EpiSwiglu, pg8::StaticOrder, true, true>(lds, g, S, E); }
            grid.sync();
            { pg8::Gemm g{F.Hb(), F.Wd() + (size_t)e * D * FF, M, D, FF}; pg8::StaticOrder S; S.init(M, D, F.G, bx);
              pg8::EpiResid E{xin, F.out, D, DN_ALPHA, 0.5f};
              pg8::gemm_phase<pg8::EpiResid, pg8::StaticOrder, true, true>(lds, g, S, E); }
        } else {
            bf16* cat = F.xb(); const int ldcat = layer == 0 ? 512 : 1024;
            if (layer == 0) { pg8::Gemm g{F.xb(), F.Wina(), M, NIN_A, D}; pg8::StaticOrder S; S.init(M, NIN_A, F.G, bx);
              pg8::EpiInproj E{F.Qb(), F.Kb(), F.Vb(), F.QMb(), F.Flog(), F.rope(), 1};
              pg8::gemm_phase<pg8::EpiInproj, pg8::StaticOrder, true, true>(lds, g, S, E); }
            else { pg8::Gemm g{F.xb(), F.Winb(), M, NIN_B, D}; pg8::StaticOrder S; S.init(M, NIN_B, F.G, bx);
              pg8::EpiInproj E{F.Qb(), F.Kb(), F.Vb(), F.QMb(), F.Flog(), F.rope(), 0};
              pg8::gemm_phase<pg8::EpiInproj, pg8::StaticOrder, true, true>(lds, g, S, E); }
            grid.sync();
            const int gw = F.vcu * NWAVES + F.wave, NGW = F.G * NWAVES;
            LAS unsigned char* wl = lds + F.wave * WL_STRIDE;
            if (layer == 0) {

#ifndef T_NO_DIL
                for (int it = gw; it < BATCH * 12 * 128; it += NGW) wave_item<true>(F, it, nullptr, nullptr, 0, 0, wl);
#endif


#ifndef T_NO_MEM
                for (int it = gw; it < BATCH * 4 * 128; it += NGW) wave_item<false>(F, it, F.memkv(), cat, ldcat, 256, wl);
#endif

                grid.sync();

#ifndef T_NO_COMB
                combine_phase(F, cat);
#endif

            } else {
                for (int p = F.vcu; p < 96 * 8; p += F.G) {
                    const int bh = p >> 3, s = p & 7, b = bh / 12, h = bh % 12;

#ifndef T_NO_SCAN
                    fox_scan(F, b, h, lds);
#endif


#ifndef T_NO_FOX
                    fox_unit(F, b, h, 15 - s, cat, ldcat, lds);
                    fox_unit(F, b, h, s, cat, ldcat, lds);
#endif

                }
                __syncthreads();

#ifndef T_NO_MEM
                for (int it = gw; it < BATCH * 4 * 128; it += NGW) wave_item<false>(F, it, F.memkv() + (size_t)MROWS * 512, cat, ldcat, 768, wl);
#endif

            }
            grid.sync();
            if (layer == 0) { pg8::Gemm g{cat, F.Wouta(), M, D, 512}; pg8::StaticOrder S; S.init(M, D, F.G, bx);
              pg8::EpiResid E{xin, F.out, D, DN_ALPHA, 1.0f};
              pg8::gemm_phase<pg8::EpiResid, pg8::StaticOrder, true, true>(lds, g, S, E); }
            else { pg8::Gemm g{cat, F.Woutb(), M, D, D}; pg8::StaticOrder S; S.init(M, D, F.G, bx);
              pg8::EpiResid E{xin, F.out, D, DN_ALPHA, 1.0f};
              pg8::gemm_phase<pg8::EpiResid, pg8::StaticOrder, true, true>(lds, g, S, E); }
        }
        grid.sync();

#ifndef T_NO_LN
        ln_phase(F, F.ln_gain + (size_t)(layer * 3 + kind) * D, F.ln_bias + (size_t)(layer * 3 + kind) * D, sub != 5);
#endif

        if (sub != 5) grid.sync();
    }
}

extern "C" void kernel_launch(void* const* d_in, const int* in_sizes, int n_in, void* d_out, int out_size, void* d_ws, size_t ws_size, hipStream_t stream) {
    static int grid = 0;
    if (grid == 0) {
        if (n_in != 14 || out_size != M * D || ws_size < WS_END) { fprintf(stderr, "kernel_launch: unexpected shapes (n_in %d out %d ws %zu)\n", n_in, out_size, ws_size); grid = -1; return; }
        int dev = 0, cus = 0, per_cu = 0;
        if (hipGetDevice(&dev) != hipSuccess || hipDeviceGetAttribute(&cus, hipDeviceAttributeMultiprocessorCount, dev) != hipSuccess) { grid = -1; return; }
        if (hipFuncSetAttribute((const void*)fwd_kernel, hipFuncAttributeMaxDynamicSharedMemorySize, LDS_BYTES) != hipSuccess) { fprintf(stderr, "kernel_launch: hipFuncSetAttribute failed\n"); grid = -1; return; }
        if (hipOccupancyMaxActiveBlocksPerMultiprocessor(&per_cu, (const void*)fwd_kernel, NWAVES * 64, LDS_BYTES) != hipSuccess || per_cu < 1) { fprintf(stderr, "kernel_launch: occupancy query says %d\n", per_cu); per_cu = 1; }
        (void)hipGetLastError();
        grid = cus;
    }
    if (grid < 0) return;
    Args a{};
    for (int i = 0; i < 14; ++i) a.in[i] = (const float*)d_in[i];
    a.out = (float*)d_out; a.ws = (unsigned char*)d_ws;
    unsigned char* ws = (unsigned char*)d_ws;
    int nj = 0, item0 = 0;
#define ADD_JOB(SRC, DST, LD, COL0, NCOLS, KK, NDST, MODE) do { TJob& J = a.jobs[nj++]; J.src = (SRC); J.dst = (bf16*)(DST); J.ld = (LD); J.col0 = (COL0); J.ncols = (NCOLS); J.K = (KK); J.nblk = (NDST) / 32; J.mode = (MODE); J.item0 = item0; J.pad = 0; item0 += ((KK) / 64) * ((NDST) / 32); } while (0)
    for (int e = 0; e < 4; ++e) {
        const float* gu = (const float*)d_in[e < 2 ? 2 : 4] + (size_t)(e & 1) * D * 2 * FF;
        const float* dn = (const float*)d_in[e < 2 ? 3 : 5] + (size_t)(e & 1) * FF * D;
        ADD_JOB(gu, ws + WS_WGU + (size_t)e * 2 * FF * D * 2, 2 * FF, 0, 2 * FF, D, 2 * FF, 1);
        ADD_JOB(dn, ws + WS_WD + (size_t)e * D * FF * 2, D, 0, D, FF, D, 0);
    }
    for (int l = 0; l < 2; ++l) ADD_JOB((const float*)d_in[8] + (size_t)l * D * 512, ws + WS_WKV + (size_t)l * 512 * D * 2, 512, 0, 512, D, 512, 0);
    ADD_JOB((const float*)d_in[9], ws + WS_WINA, NIN_A, 0, NIN_A, D, NIN_A, 0);
    ADD_JOB((const float*)d_in[10], ws + WS_WOUTA, D, 0, D, 512, D, 0);
    ADD_JOB((const float*)d_in[11], ws + WS_WINB, 2572, 0, 2304, D, 2304, 0);
    ADD_JOB((const float*)d_in[11], ws + WS_WINB + (size_t)2304 * D * 2, 2572, 2316, 256, D, 256, 0);
    ADD_JOB((const float*)d_in[11], ws + WS_WINB + (size_t)2560 * D * 2, 2572, 2304, 12, D, 256, 0);
    ADD_JOB((const float*)d_in[13], ws + WS_WOUTB, D, 0, D, D, D, 0);
#undef ADD_JOB
    a.njobs = nj; a.nitems = item0;
    void* kargs[] = {&a};
    hipError_t e = hipLaunchCooperativeKernel((const void*)fwd_kernel, dim3(grid), dim3(NWAVES * 64), kargs, LDS_BYTES, stream);
    if (e != hipSuccess) fprintf(stderr, "kernel_launch: cooperative launch failed: %s (grid %d)\n", hipGetErrorString(e), grid);
}
```
